# Optimizing an MI355X kernel written in HIP

```python
import math
import jax, jax.numpy as jnp
from jax import lax
import numpy as np

D_MODEL = 1024
BATCH = 4
SEQ = 4096
DEPTH = 2

HEAD_DIM = 64
A_HEADS = 4
A_PATTERNS = ((128, 1), (512, 4), (2048, 16))
B_HEADS = 4
B_Q_RANK = 384
B_KV_RANK = 256
B_NOPE = 64
B_ROPE = 32
B_V = 64
C_Q_HEADS = 8
C_KV_HEADS = 2
GRID_W = 64
ROPE_THETA = 10000.0
REL_BUCKETS = 32
REL_MAX_DIST = 1024
D_FF = 4 * D_MODEL
Q_BLOCK = 128
EPS = 1e-6
NEG_BIG = -1e30
ALPHA = (2 * DEPTH) ** 0.25
BETA = (8 * DEPTH) ** -0.25
ADA_INIT = 0.1

A_W = A_HEADS * HEAD_DIM
IN_SIZES = (A_W, A_W, A_W,
            B_Q_RANK, B_KV_RANK, B_ROPE,
            C_Q_HEADS * HEAD_DIM, C_KV_HEADS * HEAD_DIM, C_KV_HEADS * HEAD_DIM)
IN_COLS = sum(IN_SIZES)
IN_SPLITS = tuple(int(v) for v in np.cumsum(IN_SIZES)[:-1])
MIX_OUT = A_W + B_HEADS * B_V + C_Q_HEADS * HEAD_DIM

kernel_name = 'hybrid_dilated_mla_axialgqa_encoder'


def layer_norm(x, g, b):
    xf = x.astype(jnp.float32)
    mu = xf.mean(-1, keepdims=True)
    var = jnp.square(xf - mu).mean(-1, keepdims=True)
    return ((xf - mu) * lax.rsqrt(var + EPS) * g + b).astype(x.dtype)


def rms_norm(x, g):
    xf = x.astype(jnp.float32)
    return (xf * lax.rsqrt(jnp.square(xf).mean(-1, keepdims=True) + EPS) * g).astype(x.dtype)


def rope_angles(pos, dim):
    inv = ROPE_THETA ** (-jnp.arange(0, dim, 2, dtype=jnp.float32) / dim)
    return pos.astype(jnp.float32)[:, None] * inv[None, :]


def apply_rope(x, ang):
    xf = x.astype(jnp.float32)
    x1, x2 = jnp.split(xf, 2, axis=-1)
    cos, sin = jnp.cos(ang), jnp.sin(ang)
    return jnp.concatenate([x1 * cos - x2 * sin, x1 * sin + x2 * cos], -1).astype(x.dtype)


def axial_rope(x, ang_row, ang_col):
    half = x.shape[-1] // 2
    return jnp.concatenate([apply_rope(x[..., :half], ang_row),
                            apply_rope(x[..., half:], ang_col)], -1)


def t5_bucket(rel):
    nb = REL_BUCKETS // 2
    max_exact = nb // 2
    sign = jnp.where(rel > 0, nb, 0)
    n = jnp.abs(rel)
    nf = jnp.maximum(n, 1).astype(jnp.float32)
    large = max_exact + (jnp.log(nf / max_exact) / math.log(REL_MAX_DIST / max_exact)
                         * (nb - max_exact)).astype(jnp.int32)
    large = jnp.minimum(large, nb - 1)
    return sign + jnp.where(n < max_exact, n, large)


def dilated_window_attn(q, k, v, rel_bias, window, dilation):
    B, H, S, Dh = q.shape
    half = window // (2 * dilation)
    blk = half
    L = S // dilation
    nb = -(-L // blk)
    Lp = nb * blk

    def to_sub(t):
        return t.reshape(B, H, L, dilation, Dh).transpose(0, 1, 3, 2, 4)

    qs = jnp.pad(to_sub(q), ((0, 0), (0, 0), (0, 0), (0, Lp - L), (0, 0)))
    qb = qs.reshape(B, H, dilation, nb, blk, Dh)

    def key_blocks(t):
        tp = jnp.pad(to_sub(t), ((0, 0), (0, 0), (0, 0), (blk, Lp - L + blk), (0, 0)))
        tb = tp.reshape(B, H, dilation, nb + 2, blk, Dh)
        return jnp.concatenate([tb[:, :, :, :-2], tb[:, :, :, 1:-1], tb[:, :, :, 2:]], axis=4)

    kb, vb = key_blocks(k), key_blocks(v)
    s = jnp.einsum('bhrnqd,bhrnkd->bhrnqk', qb, kb,
                   preferred_element_type=jnp.float32) * (Dh ** -0.5)
    off = jnp.arange(3 * blk)[None, :] - blk - jnp.arange(blk)[:, None]
    bias = jnp.moveaxis(rel_bias[t5_bucket(off * dilation)], -1, 0)
    qpos = jnp.arange(nb)[:, None, None] * blk + jnp.arange(blk)[None, :, None]
    kpos = qpos + off[None]
    valid = (jnp.abs(off) <= half)[None] & (kpos >= 0) & (kpos < L)
    s = jnp.where(valid, s + bias[None, :, None, None].astype(jnp.float32), NEG_BIG)
    m = s.max(-1, keepdims=True)
    p = jnp.exp(s - m)
    l = p.sum(-1)
    o = jnp.einsum('bhrnqk,bhrnkd->bhrnqd', p, vb.astype(jnp.float32)) / l[..., None]

    def back(t):
        t = t.reshape((B, H, dilation, Lp) + t.shape[5:])[:, :, :, :L]
        t = jnp.swapaxes(t, 2, 3)
        return t.reshape((B, H, S) + t.shape[4:])

    return back(m[..., 0]), back(l), back(o)


def dilated_mixture(q, k, v, rel_bias):
    res = [dilated_window_attn(q, k, v, rel_bias, w, d) for (w, d) in A_PATTERNS]
    m_all = jnp.stack([r[0] for r in res])
    l_all = jnp.stack([r[1] for r in res])
    o_all = jnp.stack([r[2] for r in res])
    wts = l_all * jnp.exp(m_all - m_all.max(0, keepdims=True))
    o = (wts[..., None] * o_all).sum(0) / wts.sum(0)[..., None]
    return o.astype(q.dtype)


def blocked_attention(q, k, v, scale):
    B, Hq, S, Dk = q.shape
    Hkv, Dv = k.shape[1], v.shape[-1]
    G = Hq // Hkv
    qb = q.reshape(B, Hkv, G, S // Q_BLOCK, Q_BLOCK, Dk).transpose(3, 0, 1, 2, 4, 5)

    def one_block(qblk):
        s = jnp.einsum('bhgqd,bhkd->bhgqk', qblk, k, preferred_element_type=jnp.float32) * scale
        p = jax.nn.softmax(s, axis=-1)
        return jnp.einsum('bhgqk,bhkd->bhgqd', p.astype(v.dtype), v)

    o = lax.map(one_block, qb)
    return o.transpose(1, 2, 3, 0, 4, 5).reshape(B, Hq, S, Dv)


def mla_attention(cq, ckv, kr, q_norm_g, w_uq, kv_norm_g, w_ukv, ang):
    B, S, _ = cq.shape
    q = (rms_norm(cq, q_norm_g) @ w_uq).reshape(B, S, B_HEADS, B_NOPE + B_ROPE).transpose(0, 2, 1, 3)
    q = jnp.concatenate([q[..., :B_NOPE], apply_rope(q[..., B_NOPE:], ang)], -1)
    kv = (rms_norm(ckv, kv_norm_g) @ w_ukv).reshape(B, S, B_HEADS, B_NOPE + B_V).transpose(0, 2, 1, 3)
    k_rope = apply_rope(kr, ang)[:, None]
    k = jnp.concatenate([kv[..., :B_NOPE],
                         jnp.broadcast_to(k_rope, (B, B_HEADS, S, B_ROPE))], -1)
    v = kv[..., B_NOPE:]
    return blocked_attention(q, k, v, (B_NOPE + B_ROPE) ** -0.5)


def axial_gqa(q, k, v, q_norm_g, k_norm_g, ang_row, ang_col):
    B, S, _ = q.shape
    q = q.reshape(B, S, C_Q_HEADS, HEAD_DIM).transpose(0, 2, 1, 3)
    k = k.reshape(B, S, C_KV_HEADS, HEAD_DIM).transpose(0, 2, 1, 3)
    v = v.reshape(B, S, C_KV_HEADS, HEAD_DIM).transpose(0, 2, 1, 3)
    q = axial_rope(rms_norm(q, q_norm_g), ang_row, ang_col)
    k = axial_rope(rms_norm(k, k_norm_g), ang_row, ang_col)
    return blocked_attention(q, k, v, HEAD_DIM ** -0.5)


def heads_to_seq(o):
    B, H, S, D = o.shape
    return o.transpose(0, 2, 1, 3).reshape(B, S, H * D)


def setup_inputs(seed: int = 0) -> dict:
    key = jax.random.key(seed)
    ks = jax.random.split(key, 20)
    f32 = jnp.float32
    nrm = lambda k, shape, s: jax.random.normal(k, shape, f32) * s
    gain = lambda k, shape: 1.0 + 0.01 * jax.random.normal(k, shape, f32)
    return {
        'x': nrm(ks[0], (BATCH, SEQ, D_MODEL), 1.0),
        'c': nrm(ks[1], (BATCH, D_MODEL), 1.0),
        'w_ada': nrm(ks[2], (DEPTH, D_MODEL, 6 * D_MODEL), ADA_INIT * D_MODEL ** -0.5),
        'b_ada': nrm(ks[3], (DEPTH, 6 * D_MODEL), 0.01),
        'w_in': nrm(ks[4], (DEPTH, D_MODEL, IN_COLS), D_MODEL ** -0.5),
        'mla_q_norm': gain(ks[5], (DEPTH, B_Q_RANK)),
        'mla_w_uq': nrm(ks[6], (DEPTH, B_Q_RANK, B_HEADS * (B_NOPE + B_ROPE)), B_Q_RANK ** -0.5),
        'mla_kv_norm': gain(ks[7], (DEPTH, B_KV_RANK)),
        'mla_w_ukv': nrm(ks[8], (DEPTH, B_KV_RANK, B_HEADS * (B_NOPE + B_V)), B_KV_RANK ** -0.5),
        'gqa_q_norm': gain(ks[9], (DEPTH, HEAD_DIM)),
        'gqa_k_norm': gain(ks[10], (DEPTH, HEAD_DIM)),
        'rel_bias': nrm(ks[11], (REL_BUCKETS, A_HEADS), 0.5),
        'w_o': nrm(ks[12], (DEPTH, MIX_OUT, D_MODEL), BETA * MIX_OUT ** -0.5),
        'ln1_g': gain(ks[13], (DEPTH, D_MODEL)),
        'ln1_b': nrm(ks[14], (DEPTH, D_MODEL), 0.01),
        'w1': nrm(ks[15], (DEPTH, D_MODEL, D_FF), D_MODEL ** -0.5),
        'w2': nrm(ks[16], (DEPTH, D_FF, D_MODEL), BETA * D_FF ** -0.5),
        'ln2_g': gain(ks[17], (DEPTH, D_MODEL)),
        'ln2_b': nrm(ks[18], (DEPTH, D_MODEL), 0.01),
    }


def reference(x, c, w_ada, b_ada, w_in, mla_q_norm, mla_w_uq, mla_kv_norm, mla_w_ukv,
              gqa_q_norm, gqa_k_norm, rel_bias, w_o, ln1_g, ln1_b, w1, w2, ln2_g, ln2_b):
    B, S, D = x.shape
    ROWS = S // GRID_W
    t = jnp.arange(S)
    rows = jnp.repeat(jnp.arange(ROWS), GRID_W)
    cols = jnp.tile(jnp.arange(GRID_W), ROWS)
    ang_t = rope_angles(t, B_ROPE)
    ang_row = rope_angles(rows, HEAD_DIM // 2)
    ang_col = rope_angles(cols, HEAD_DIM // 2)
    c_act = jax.nn.silu(c)

    for l in range(DEPTH):
        mod = (c_act @ w_ada[l] + b_ada[l])[:, None, :]
        sh_a, sc_a, g_a, sh_m, sc_m, g_m = jnp.split(mod, 6, axis=-1)

        h = x * (1.0 + sc_a) + sh_a
        proj = h @ w_in[l]
        a_q, a_k, a_v, b_cq, b_ckv, b_kr, c_q, c_k, c_v = jnp.split(proj, IN_SPLITS, axis=-1)
        to_heads = lambda z: z.reshape(B, S, A_HEADS, HEAD_DIM).transpose(0, 2, 1, 3)
        y_a = dilated_mixture(to_heads(a_q), to_heads(a_k), to_heads(a_v), rel_bias)
        y_b = mla_attention(b_cq, b_ckv, b_kr, mla_q_norm[l], mla_w_uq[l],
                            mla_kv_norm[l], mla_w_ukv[l], ang_t)
        y_c = axial_gqa(c_q, c_k, c_v, gqa_q_norm[l], gqa_k_norm[l], ang_row, ang_col)
        y = jnp.concatenate([heads_to_seq(y_a), heads_to_seq(y_b), heads_to_seq(y_c)], -1) @ w_o[l]
        x = layer_norm(ALPHA * x + (1.0 + g_a) * y, ln1_g[l], ln1_b[l])

        h = x * (1.0 + sc_m) + sh_m
        y = jnp.square(jax.nn.relu(h @ w1[l])) @ w2[l]
        x = layer_norm(ALPHA * x + (1.0 + g_m) * y, ln2_g[l], ln2_b[l])
    return x
```

```cpp
#include <hip/hip_runtime.h>
#include <math.h>

namespace nv {
constexpr int D = 1024, NB = 4, S = 4096, DEPTH = 2, INC = 2208, DFF = 4096;
constexpr float EPS = 1e-6f;
constexpr float ALPHA = 1.41421356237309515f;

__global__ void k_tables(float* cs, float* sn, float* btab, const float* rel_bias) {
    const int i = blockIdx.x * blockDim.x + threadIdx.x;
    if (i < S * 16) {
        const int pos = i / 16, f = i % 16;
        const double inv = exp(-(double)(2 * f) / 32.0 * log(10000.0));
        const double a = (double)pos * inv;
        cs[i] = (float)cos(a); sn[i] = (float)sin(a);
    }
    if (i < 3 * 4 * 129) {
        const int p = i / (4 * 129), h = (i / 129) % 4, j = i % 129 - 64;
        const int d = p == 0 ? 1 : (p == 1 ? 4 : 16);
        const int rel = j * d, n = rel < 0 ? -rel : rel;
        int bk = rel > 0 ? 16 : 0;
        if (n < 8) bk += n;
        else { int c = 8; c += (n >= 15); c += (n >= 27); c += (n >= 50); c += (n >= 91); c += (n >= 166); c += (n >= 305); c += (n >= 559); bk += c; }
        btab[i] = rel_bias[bk * 4 + h];
    }
}

__global__ void k_mod(const float* c, const float* w_ada, const float* b_ada, float* mod) {
    const int i = blockIdx.x * blockDim.x + threadIdx.x;
    if (i >= DEPTH * NB * 6 * D) return;
    const int n = i % (6 * D), b = (i / (6 * D)) % NB, l = i / (6 * D * NB);
    const float* w = w_ada + (size_t)l * D * 6 * D + n;
    float acc = 0.f;
    for (int k = 0; k < D; ++k) { const float cv = c[b * D + k]; const float sv = cv / (1.f + expf(-cv)); acc += sv * w[(size_t)k * 6 * D]; }
    mod[i] = acc + b_ada[l * 6 * D + n];
}

__global__ void k_modh(const float* x, const float* sh, const float* sc, float* h, int rows) {
    const size_t i = (size_t)blockIdx.x * blockDim.x + threadIdx.x;
    if (i >= (size_t)rows * D) return;
    const int c = (int)(i % D);
    h[i] = x[i] * (1.f + sc[c]) + sh[c];
}

template <int EPI>
__global__ __launch_bounds__(256) void k_gemm(const float* A, int lda, const float* B, int ldb, float* C, int ldc, int N, int K) {
    __shared__ float As[16][68];
    __shared__ float Bs[16][68];
    const int tid = threadIdx.x, tx = tid % 16, ty = tid / 16;
    const int m0 = blockIdx.y * 64, n0 = blockIdx.x * 64;
    float acc[4][4];
#pragma unroll
    for (int i = 0; i < 4; ++i)
#pragma unroll
        for (int j = 0; j < 4; ++j) acc[i][j] = 0.f;
    for (int k0 = 0; k0 < K; k0 += 16) {
        { const int r = tid / 4, cc = (tid % 4) * 4; const float4 v = *(const float4*)(A + (size_t)(m0 + r) * lda + k0 + cc);
          As[cc + 0][r] = v.x; As[cc + 1][r] = v.y; As[cc + 2][r] = v.z; As[cc + 3][r] = v.w; }
        { const int r = tid / 16, cc = (tid % 16) * 4; float4 v = make_float4(0.f, 0.f, 0.f, 0.f);
          if (n0 + cc < N) v = *(const float4*)(B + (size_t)(k0 + r) * ldb + n0 + cc);
          Bs[r][cc + 0] = v.x; Bs[r][cc + 1] = v.y; Bs[r][cc + 2] = v.z; Bs[r][cc + 3] = v.w; }
        __syncthreads();
#pragma unroll
        for (int kk = 0; kk < 16; ++kk) {
            float a[4], b[4];
#pragma unroll
            for (int i = 0; i < 4; ++i) { a[i] = As[kk][ty * 4 + i]; b[i] = Bs[kk][tx * 4 + i]; }
#pragma unroll
            for (int i = 0; i < 4; ++i)
#pragma unroll
                for (int j = 0; j < 4; ++j) acc[i][j] += a[i] * b[j];
        }
        __syncthreads();
    }
    if (n0 + tx * 4 < N) {
#pragma unroll
        for (int i = 0; i < 4; ++i) {
            float4 v = make_float4(acc[i][0], acc[i][1], acc[i][2], acc[i][3]);
            if (EPI == 1) { v.x = v.x > 0.f ? v.x * v.x : 0.f; v.y = v.y > 0.f ? v.y * v.y : 0.f; v.z = v.z > 0.f ? v.z * v.z : 0.f; v.w = v.w > 0.f ? v.w * v.w : 0.f; }
            *(float4*)(C + (size_t)(m0 + ty * 4 + i) * ldc + n0 + tx * 4) = v;
        }
    }
}

__device__ __forceinline__ float wave_sum(float v) {
#pragma unroll
    for (int o = 1; o < 64; o <<= 1) v += __shfl_xor(v, o);
    return v;
}

__global__ void k_rms_rows(const float* in, int lds_, int n, const float* g, float* out, int ldo, int rows) {
    const int w = (blockIdx.x * blockDim.x + threadIdx.x) / 64, lane = threadIdx.x % 64;
    if (w >= rows) return;
    const float* p = in + (size_t)w * lds_;
    float s = 0.f;
    for (int i = lane; i < n; i += 64) s += p[i] * p[i];
    s = wave_sum(s);
    const float r = 1.f / sqrtf(s / (float)n + EPS);
    for (int i = lane; i < n; i += 64) out[(size_t)w * ldo + i] = p[i] * r * g[i];
}

__global__ void k_mla_fix(float* qb, const float* kvb, const float* proj, float* kfull, const float* cs, const float* sn) {
    const int i = blockIdx.x * blockDim.x + threadIdx.x;
    if (i >= S * 4) return;
    const int t = i / 4, h = i % 4;
    float* q = qb + (size_t)t * 384 + h * 96 + 64;
    const float* kr = proj + (size_t)t * INC + 1408;
    float* kf = kfull + (size_t)t * 384 + h * 96;
    const float* kn = kvb + (size_t)t * 512 + h * 128;
    for (int d = 0; d < 64; ++d) kf[d] = kn[d];
    for (int f = 0; f < 16; ++f) {
        const float c = cs[t * 16 + f], s = sn[t * 16 + f];
        const float x1 = q[f], x2 = q[f + 16];
        q[f] = x1 * c - x2 * s; q[f + 16] = x1 * s + x2 * c;
        const float k1 = kr[f], k2 = kr[f + 16];
        kf[64 + f] = k1 * c - k2 * s; kf[64 + f + 16] = k1 * s + k2 * c;
    }
}

__global__ void k_gqa_fix(const float* in, int ldi, int nh, const float* g, float* out, const float* cs, const float* sn) {
    const int i = blockIdx.x * blockDim.x + threadIdx.x;
    if (i >= S * nh) return;
    const int t = i / nh, h = i % nh;
    const float* p = in + (size_t)t * ldi + h * 64;
    float* o = out + (size_t)t * (nh * 64) + h * 64;
    float ss = 0.f;
    for (int d = 0; d < 64; ++d) ss += p[d] * p[d];
    const float r = 1.f / sqrtf(ss / 64.f + EPS);
    const int row = t / 64, col = t % 64;
    for (int f = 0; f < 16; ++f) {
        { const float c = cs[row * 16 + f], s = sn[row * 16 + f];
          const float x1 = p[f] * r * g[f], x2 = p[f + 16] * r * g[f + 16];
          o[f] = x1 * c - x2 * s; o[f + 16] = x1 * s + x2 * c; }
        { const float c = cs[col * 16 + f], s = sn[col * 16 + f];
          const float x1 = p[32 + f] * r * g[32 + f], x2 = p[48 + f] * r * g[48 + f];
          o[32 + f] = x1 * c - x2 * s; o[48 + f] = x1 * s + x2 * c; }
    }
}

template <int DK, int DV>
__global__ __launch_bounds__(256) void k_attn(const float* Q, int qs, int qh, const float* K, int ks, int kh, int group,
                                              const float* V, int vs, int vh, float* O, int os, int oh, float scale) {
    __shared__ float Ks[32][DK];
    __shared__ float Vs[32][DV];
    const int h = blockIdx.y, hk = h / group, t = blockIdx.x * 256 + threadIdx.x;
    float q[DK], o[DV];
#pragma unroll
    for (int i = 0; i < DK; ++i) q[i] = Q[(size_t)t * qs + h * qh + i] * scale;
#pragma unroll
    for (int i = 0; i < DV; ++i) o[i] = 0.f;
    float m = -1e30f, l = 0.f;
    for (int s0 = 0; s0 < S; s0 += 32) {
        for (int i = threadIdx.x; i < 32 * DK; i += 256) Ks[i / DK][i % DK] = K[(size_t)(s0 + i / DK) * ks + hk * kh + i % DK];
        for (int i = threadIdx.x; i < 32 * DV; i += 256) Vs[i / DV][i % DV] = V[(size_t)(s0 + i / DV) * vs + hk * vh + i % DV];
        __syncthreads();
        for (int j = 0; j < 32; ++j) {
            float sc = 0.f;
#pragma unroll
            for (int i = 0; i < DK; ++i) sc += q[i] * Ks[j][i];
            if (sc > m) { const float a = expf(m - sc); l *= a;
#pragma unroll
                for (int i = 0; i < DV; ++i) o[i] *= a;
                m = sc; }
            const float p = expf(sc - m); l += p;
#pragma unroll
            for (int i = 0; i < DV; ++i) o[i] += p * Vs[j][i];
        }
        __syncthreads();
    }
    const float rl = 1.f / l;
#pragma unroll
    for (int i = 0; i < DV; ++i) O[(size_t)t * os + h * oh + i] = o[i] * rl;
}

__global__ __launch_bounds__(256) void k_dilated(const float* proj, const float* btab, float* ycat) {
    const int i = blockIdx.x * 256 + threadIdx.x;
    const int h = blockIdx.y, t = i;
    if (t >= S) return;
    float q[64], o[64];
#pragma unroll
    for (int d = 0; d < 64; ++d) { q[d] = proj[(size_t)t * INC + h * 64 + d] * 0.125f; o[d] = 0.f; }
    float m = -1e30f, l = 0.f;
    for (int p = 0; p < 3; ++p) {
        const int dil = p == 0 ? 1 : (p == 1 ? 4 : 16);
        for (int j = -64; j <= 64; ++j) {
            const int tok = t + j * dil;
            if (tok < 0 || tok >= S) continue;
            const float4* kp = (const float4*)(proj + (size_t)tok * INC + 256 + h * 64);
            const float4* vp = (const float4*)(proj + (size_t)tok * INC + 512 + h * 64);
            float sc = btab[(p * 4 + h) * 129 + j + 64];
#pragma unroll
            for (int d = 0; d < 16; ++d) { const float4 kv = kp[d]; sc += q[4 * d] * kv.x + q[4 * d + 1] * kv.y + q[4 * d + 2] * kv.z + q[4 * d + 3] * kv.w; }
            if (sc > m) { const float a = expf(m - sc); l *= a;
#pragma unroll
                for (int d = 0; d < 64; ++d) o[d] *= a;
                m = sc; }
            const float pe = expf(sc - m); l += pe;
#pragma unroll
            for (int d = 0; d < 16; ++d) { const float4 vv = vp[d]; o[4 * d] += pe * vv.x; o[4 * d + 1] += pe * vv.y; o[4 * d + 2] += pe * vv.z; o[4 * d + 3] += pe * vv.w; }
        }
    }
    const float rl = 1.f / l;
#pragma unroll
    for (int d = 0; d < 64; ++d) ycat[(size_t)t * D + h * 64 + d] = o[d] * rl;
}

__global__ void k_ln(const float* x, const float* y, const float* gate, const float* gamma, const float* beta, float* out, int rows) {
    const int w = (blockIdx.x * blockDim.x + threadIdx.x) / 64, lane = threadIdx.x % 64;
    if (w >= rows) return;
    float v[16]; float s = 0.f;
#pragma unroll
    for (int j = 0; j < 16; ++j) { const int c = lane + 64 * j; v[j] = ALPHA * x[(size_t)w * D + c] + (1.f + gate[c]) * y[(size_t)w * D + c]; s += v[j]; }
    const float mean = wave_sum(s) * (1.f / D);
    float s2 = 0.f;
#pragma unroll
    for (int j = 0; j < 16; ++j) { v[j] -= mean; s2 += v[j] * v[j]; }
    const float rstd = 1.f / sqrtf(wave_sum(s2) * (1.f / D) + EPS);
#pragma unroll
    for (int j = 0; j < 16; ++j) { const int c = lane + 64 * j; out[(size_t)w * D + c] = v[j] * rstd * gamma[c] + beta[c]; }
}
}

extern "C" void kernel_launch(void* const* d_in, const int* in_sizes, int n_in, void* d_out, int out_size, void* d_ws, size_t ws_size, hipStream_t stream) {
    using namespace nv;
    const float* x_in = (const float*)d_in[0];
    const float* c = (const float*)d_in[1];
    const float* w_ada = (const float*)d_in[2];
    const float* b_ada = (const float*)d_in[3];
    const float* w_in = (const float*)d_in[4];
    const float* q_norm = (const float*)d_in[5];
    const float* w_uq = (const float*)d_in[6];
    const float* kv_norm = (const float*)d_in[7];
    const float* w_ukv = (const float*)d_in[8];
    const float* gq_norm = (const float*)d_in[9];
    const float* gk_norm = (const float*)d_in[10];
    const float* rel_bias = (const float*)d_in[11];
    const float* w_o = (const float*)d_in[12];
    const float* ln1_g = (const float*)d_in[13];
    const float* ln1_b = (const float*)d_in[14];
    const float* w1 = (const float*)d_in[15];
    const float* w2 = (const float*)d_in[16];
    const float* ln2_g = (const float*)d_in[17];
    const float* ln2_b = (const float*)d_in[18];
    float* out = (float*)d_out;
    float* ws = (float*)d_ws;
    size_t off = 0;
    auto take = [&](size_t n) { float* p = ws + off; off += (n + 63) / 64 * 64; return p; };
    float* mod = take((size_t)DEPTH * NB * 6 * D);
    float* cs = take((size_t)S * 16);
    float* sn = take((size_t)S * 16);
    float* btab = take(3 * 4 * 129);
    float* hbuf = take((size_t)S * D);
    float* proj = take((size_t)S * INC);
    float* cqn = take((size_t)S * 384);
    float* ckvn = take((size_t)S * 256);
    float* qb = take((size_t)S * 384);
    float* kvb = take((size_t)S * 512);
    float* kfull = take((size_t)S * 384);
    float* cqr = take((size_t)S * 512);
    float* ckr = take((size_t)S * 128);
    float* ycat = take((size_t)S * D);
    float* ybuf = take((size_t)S * D);
    float* ubuf = take((size_t)S * DFF);
    (void)ws_size; (void)in_sizes; (void)n_in; (void)out_size;

    k_tables<<<(S * 16 + 255) / 256, 256, 0, stream>>>(cs, sn, btab, rel_bias);
    k_mod<<<(DEPTH * NB * 6 * D + 255) / 256, 256, 0, stream>>>(c, w_ada, b_ada, mod);

    for (int l = 0; l < DEPTH; ++l) {
        for (int b = 0; b < NB; ++b) {
            const float* xb = (l == 0 ? x_in : out) + (size_t)b * S * D;
            float* ob = out + (size_t)b * S * D;
            const float* md = mod + ((size_t)l * NB + b) * 6 * D;
            const float *sh_a = md, *sc_a = md + D, *g_a = md + 2 * D, *sh_m = md + 3 * D, *sc_m = md + 4 * D, *g_m = md + 5 * D;
            k_modh<<<(S * D + 255) / 256, 256, 0, stream>>>(xb, sh_a, sc_a, hbuf, S);
            k_gemm<0><<<dim3((INC + 63) / 64, S / 64), 256, 0, stream>>>(hbuf, D, w_in + (size_t)l * D * INC, INC, proj, INC, INC, D);
            k_rms_rows<<<S / 4, 256, 0, stream>>>(proj + 768, INC, 384, q_norm + l * 384, cqn, 384, S);
            k_rms_rows<<<S / 4, 256, 0, stream>>>(proj + 1152, INC, 256, kv_norm + l * 256, ckvn, 256, S);
            k_gemm<0><<<dim3(384 / 64, S / 64), 256, 0, stream>>>(cqn, 384, w_uq + (size_t)l * 384 * 384, 384, qb, 384, 384, 384);
            k_gemm<0><<<dim3(512 / 64, S / 64), 256, 0, stream>>>(ckvn, 256, w_ukv + (size_t)l * 256 * 512, 512, kvb, 512, 512, 256);
            k_mla_fix<<<(S * 4 + 255) / 256, 256, 0, stream>>>(qb, kvb, proj, kfull, cs, sn);
            k_gqa_fix<<<(S * 8 + 255) / 256, 256, 0, stream>>>(proj + 1440, INC, 8, gq_norm + l * 64, cqr, cs, sn);
            k_gqa_fix<<<(S * 2 + 255) / 256, 256, 0, stream>>>(proj + 1952, INC, 2, gk_norm + l * 64, ckr, cs, sn);
            k_dilated<<<dim3(S / 256, 4), 256, 0, stream>>>(proj, btab, ycat);
            k_attn<96, 64><<<dim3(S / 256, 4), 256, 0, stream>>>(qb, 384, 96, kfull, 384, 96, 1, kvb + 64, 512, 128, ycat + 256, D, 64, 0.10206207261596577f);
            k_attn<64, 64><<<dim3(S / 256, 8), 256, 0, stream>>>(cqr, 512, 64, ckr, 128, 64, 4, proj + 2080, INC, 64, ycat + 512, D, 64, 0.125f);
            k_gemm<0><<<dim3(D / 64, S / 64), 256, 0, stream>>>(ycat, D, w_o + (size_t)l * D * D, D, ybuf, D, D, D);
            k_ln<<<S / 4, 256, 0, stream>>>(xb, ybuf, g_a, ln1_g + l * D, ln1_b + l * D, ob, S);
            k_modh<<<(S * D + 255) / 256, 256, 0, stream>>>(ob, sh_m, sc_m, hbuf, S);
            k_gemm<1><<<dim3(DFF / 64, S / 64), 256, 0, stream>>>(hbuf, D, w1 + (size_t)l * D * DFF, DFF, ubuf, DFF, DFF, D);
            k_gemm<0><<<dim3(D / 64, S / 64), 256, 0, stream>>>(ubuf, DFF, w2 + (size_t)l * DFF * D, D, ybuf, D, D, DFF);
            k_ln<<<S / 4, 256, 0, stream>>>(ob, ybuf, g_m, ln2_g + l * D, ln2_b + l * D, ob, S);
        }
    }
}
```
